# Optimizing an MI355X kernel written in HIP

```python
import math
import jax, jax.numpy as jnp
from jax import lax
import numpy as np

D_MODEL = 1024
BATCH = 8
SEQ = 2048
DEPTH = 1

CHUNK = 64
D_MIX = D_MODEL
RWKV_HEADS = 8
RWKV_HEAD_DIM = 64
RWKV_WIDTH = RWKV_HEADS * RWKV_HEAD_DIM
DECAY_RANK = 64
A_RANK = 64
GATE_RANK = 128
GN_EPS = 64e-5
ATTN_HEADS = 8
ATTN_HEAD_DIM = 64
ATTN_WIDTH = ATTN_HEADS * ATTN_HEAD_DIM
IDX_HEADS = 8
IDX_DIM = 64
MAX_TOPK = 256
Q_BLOCK = 64
REL_BUCKETS = 32
REL_MAX_DISTANCE = 128
D_FF = 4 * D_MODEL
PLE_DIM = 256
NORM_EPS = 1e-6
LN_EPS = 1e-6
NEG_INF = -1e30

RWKV_SPLITS = (RWKV_WIDTH, DECAY_RANK, RWKV_WIDTH, RWKV_WIDTH, A_RANK, GATE_RANK)
RWKV_COLS = sum(RWKV_SPLITS)
DSA_SPLITS = (ATTN_WIDTH, ATTN_WIDTH, ATTN_WIDTH, IDX_HEADS * IDX_DIM, IDX_DIM, IDX_HEADS)
DSA_COLS = sum(DSA_SPLITS)
IN_COLS = RWKV_COLS + DSA_COLS

kernel_name = 'hybrid_rwkv7_dsa_stream_block'


def _split(z, sizes):
    idx, acc = [], 0
    for s in sizes[:-1]:
        acc += s
        idx.append(acc)
    return jnp.split(z, idx, axis=-1)


def rms_norm(x, g):
    xf = x.astype(jnp.float32)
    y = xf * lax.rsqrt(jnp.mean(xf * xf, axis=-1, keepdims=True) + NORM_EPS) * g.astype(jnp.float32)
    return y.astype(x.dtype)


def t5_bucket(rel):
    half = REL_BUCKETS // 2
    max_exact = half // 2
    ret = jnp.where(rel > 0, half, 0)
    n = jnp.abs(rel)
    nf = jnp.maximum(n, 1).astype(jnp.float32)
    large = max_exact + (jnp.log(nf / max_exact) / math.log(REL_MAX_DISTANCE / max_exact)
                         * (half - max_exact)).astype(jnp.int32)
    large = jnp.minimum(large, half - 1)
    return ret + jnp.where(n < max_exact, n, large)


def rwkv7_time_mix(z, mu, w0, w2, a0, a2, g2, k_k, k_a, r_k, ln_g, ln_b):
    B, S, _ = z.shape
    H, N = RWKV_HEADS, RWKV_HEAD_DIM
    f32 = jnp.float32
    z = z.astype(f32)
    z_prev = jnp.pad(z, ((0, 0), (1, 0), (0, 0)))[:, :-1]
    z = z + (z_prev - z) * mu.astype(f32)
    r, zw, k, v, za, zg = _split(z, RWKV_SPLITS)
    w_log = -jax.nn.softplus(-(w0.astype(f32) + jnp.tanh(zw) @ w2.astype(f32))) - 0.5
    decay = jnp.exp(-jnp.exp(w_log))
    a = jax.nn.sigmoid(a0.astype(f32) + za @ a2.astype(f32))
    g = jax.nn.sigmoid(zg) @ g2.astype(f32)
    hs = lambda t: t.reshape(B, S, H, N)
    r, decay, k, v, a = hs(r), hs(decay), hs(k), hs(v), hs(a)
    kk = k * k_k.astype(f32).reshape(H, N)
    kk = kk / jnp.maximum(jnp.sqrt(jnp.sum(kk * kk, axis=-1, keepdims=True)), 1e-12)
    k = k * (1.0 + (a - 1.0) * k_a.astype(f32).reshape(H, N))

    def step(state, inp):
        r_t, w_t, k_t, v_t, kk_t, a_t = inp
        sa = jnp.einsum('bhvk,bhk->bhv', state, -kk_t)
        state = (state * w_t[:, :, None, :]
                 + sa[..., :, None] * (kk_t * a_t)[..., None, :]
                 + v_t[..., :, None] * k_t[..., None, :])
        return state, jnp.einsum('bhvk,bhk->bhv', state, r_t)

    seq_first = lambda t: jnp.swapaxes(t, 0, 1)
    state0 = jnp.zeros((B, H, N, N), f32)
    _, o = lax.scan(step, state0, (seq_first(r), seq_first(decay), seq_first(k),
                                   seq_first(v), seq_first(kk), seq_first(a)))
    o = seq_first(o)
    mean = jnp.mean(o, axis=-1, keepdims=True)
    var = jnp.mean(jnp.square(o - mean), axis=-1, keepdims=True)
    o = (o - mean) * lax.rsqrt(var + GN_EPS) * ln_g.astype(f32).reshape(H, N) + ln_b.astype(f32).reshape(H, N)
    o = o + jnp.sum(r * k * r_k.astype(f32), axis=-1, keepdims=True) * v
    return o.reshape(B, S, RWKV_WIDTH) * g


def dsa_attention(z, k_ln_g, k_ln_b, rel_bias):
    B, S, _ = z.shape
    f32 = jnp.float32
    q, k, v, qi, ki, wi = _split(z, DSA_SPLITS)
    q = q.reshape(B, S, ATTN_HEADS, ATTN_HEAD_DIM)
    k = k.reshape(B, S, ATTN_HEADS, ATTN_HEAD_DIM)
    v = v.reshape(B, S, ATTN_HEADS, ATTN_HEAD_DIM)
    qi = qi.reshape(B, S, IDX_HEADS, IDX_DIM).astype(f32)
    kf = ki.astype(f32)
    k_mean = jnp.mean(kf, axis=-1, keepdims=True)
    k_var = jnp.mean(jnp.square(kf - k_mean), axis=-1, keepdims=True)
    ki = (kf - k_mean) * lax.rsqrt(k_var + LN_EPS) * k_ln_g.astype(f32) + k_ln_b.astype(f32)
    wi = wi.astype(f32) * IDX_HEADS ** -0.5
    topk = min(MAX_TOPK, S // 4)
    n_blocks = S // Q_BLOCK
    key_pos = jnp.arange(S)
    scale = ATTN_HEAD_DIM ** -0.5
    idx_scale = IDX_DIM ** -0.5
    gather = jax.vmap(lambda t, i: t[i])
    table = rel_bias.astype(f32)

    def block(blk):
        t0 = blk * Q_BLOCK
        q_pos = t0 + jnp.arange(Q_BLOCK)
        chunk_end = (q_pos // CHUNK + 1) * CHUNK
        qb = lax.dynamic_slice_in_dim(q, t0, Q_BLOCK, axis=1).astype(f32)
        qib = lax.dynamic_slice_in_dim(qi, t0, Q_BLOCK, axis=1)
        wib = lax.dynamic_slice_in_dim(wi, t0, Q_BLOCK, axis=1)
        act = jax.nn.relu(jnp.einsum('bqhd,bsd->bqsh', qib, ki) * idx_scale)
        score = jnp.einsum('bqsh,bqh->bqs', act, wib)
        score = jnp.where(key_pos[None, None, :] < chunk_end[None, :, None], score, -jnp.inf)
        _, sel = lax.top_k(score, topk)
        valid = sel < chunk_end[None, :, None]
        k_sel = gather(k, sel).astype(f32)
        v_sel = gather(v, sel).astype(f32)
        bias = table[t5_bucket(sel - q_pos[None, :, None])]
        logits = jnp.einsum('bqhd,bqkhd->bqkh', qb, k_sel) * scale + bias
        logits = jnp.where(valid[..., None], logits, NEG_INF)
        probs = jax.nn.softmax(logits, axis=2)
        return jnp.einsum('bqkh,bqkhd->bqhd', probs, v_sel)

    o = lax.map(block, jnp.arange(n_blocks))
    return jnp.swapaxes(o, 0, 1).reshape(B, S, ATTN_WIDTH)


def setup_inputs(seed: int = 0) -> dict:
    key = jax.random.key(seed)
    ks = iter(jax.random.split(key, 32))
    nrm = lambda shape, s: jax.random.normal(next(ks), shape, jnp.float32) * s
    gain = lambda shape: 1.0 + nrm(shape, 0.05)
    H, N = RWKV_HEADS, RWKV_HEAD_DIM
    return {
        'x': nrm((BATCH, SEQ, D_MODEL), 1.0),
        'p': nrm((DEPTH, BATCH, SEQ, PLE_DIM), 1.0),
        'w_in': nrm((DEPTH, D_MODEL, IN_COLS), D_MODEL ** -0.5),
        'shift_mu': jax.random.uniform(next(ks), (DEPTH, RWKV_COLS), jnp.float32),
        'rwkv_w0': nrm((DEPTH, RWKV_WIDTH), 1.0) - 1.0,
        'rwkv_w2': nrm((DEPTH, DECAY_RANK, RWKV_WIDTH), 0.5 * DECAY_RANK ** -0.5),
        'rwkv_a0': nrm((DEPTH, RWKV_WIDTH), 0.1),
        'rwkv_a2': nrm((DEPTH, A_RANK, RWKV_WIDTH), 0.5 * A_RANK ** -0.5),
        'rwkv_g2': nrm((DEPTH, GATE_RANK, RWKV_WIDTH), GATE_RANK ** -0.5),
        'rwkv_k_k': 0.85 + nrm((DEPTH, RWKV_WIDTH), 0.05),
        'rwkv_k_a': 1.0 + nrm((DEPTH, RWKV_WIDTH), 0.05),
        'rwkv_r_k': nrm((DEPTH, H, N), 0.1),
        'rwkv_ln_g': gain((DEPTH, RWKV_WIDTH)),
        'rwkv_ln_b': nrm((DEPTH, RWKV_WIDTH), 0.02),
        'idx_k_ln_g': gain((DEPTH, IDX_DIM)),
        'idx_k_ln_b': nrm((DEPTH, IDX_DIM), 0.02),
        'rel_bias': nrm((REL_BUCKETS, ATTN_HEADS), 0.5),
        'w_out': nrm((DEPTH, D_MIX, D_MODEL), D_MIX ** -0.5),
        'w_ffn1': nrm((DEPTH, D_MODEL, D_FF), D_MODEL ** -0.5),
        'w_ffn2': nrm((DEPTH, D_FF, D_MODEL), D_FF ** -0.5),
        'w_ple': nrm((DEPTH, PLE_DIM, D_MODEL), PLE_DIM ** -0.5),
        'w_ple_gate': nrm((DEPTH, D_MODEL, D_MODEL), D_MODEL ** -0.5),
        'norm_mix_pre': gain((DEPTH, D_MODEL)),
        'norm_mix_post': gain((DEPTH, D_MODEL)),
        'norm_ffn_pre': gain((DEPTH, D_MODEL)),
        'norm_ffn_post': gain((DEPTH, D_MODEL)),
        'norm_ple_pre': gain((DEPTH, D_MODEL)),
        'norm_ple_post': gain((DEPTH, D_MODEL)),
    }


def reference(x, p, w_in, shift_mu, rwkv_w0, rwkv_w2, rwkv_a0, rwkv_a2, rwkv_g2,
              rwkv_k_k, rwkv_k_a, rwkv_r_k, rwkv_ln_g, rwkv_ln_b, idx_k_ln_g, idx_k_ln_b,
              rel_bias, w_out, w_ffn1, w_ffn2, w_ple, w_ple_gate,
              norm_mix_pre, norm_mix_post, norm_ffn_pre, norm_ffn_post,
              norm_ple_pre, norm_ple_post):
    for i in range(DEPTH):
        h = rms_norm(x, norm_mix_pre[i])
        z = h @ w_in[i]
        z_rwkv, z_dsa = z[..., :RWKV_COLS], z[..., RWKV_COLS:]
        y_rwkv = rwkv7_time_mix(z_rwkv, shift_mu[i], rwkv_w0[i], rwkv_w2[i], rwkv_a0[i],
                                rwkv_a2[i], rwkv_g2[i], rwkv_k_k[i], rwkv_k_a[i],
                                rwkv_r_k[i], rwkv_ln_g[i], rwkv_ln_b[i])
        y_dsa = dsa_attention(z_dsa, idx_k_ln_g[i], idx_k_ln_b[i], rel_bias)
        mix = jnp.concatenate([y_rwkv, y_dsa], axis=-1).astype(x.dtype) @ w_out[i]
        x = x + rms_norm(mix, norm_mix_post[i])
        h = rms_norm(x, norm_ffn_pre[i])
        f = jnp.square(jax.nn.relu(h @ w_ffn1[i])) @ w_ffn2[i]
        x = x + rms_norm(f, norm_ffn_post[i])
        gate = jax.nn.sigmoid(rms_norm(x, norm_ple_pre[i]) @ w_ple_gate[i])
        x = x + rms_norm((p[i] @ w_ple[i]) * gate, norm_ple_post[i])
    return x
```

```cpp
#include <hip/hip_runtime.h>
#include <cstdio>
#include <cstdint>

constexpr int D = 1024, NB = 8, S = 2048, M = NB * S;
constexpr int RCOLS = 1792, DCOLS = 2120, ZC = 3912, DFF = 4096, PLE = 256;
constexpr int GB = 2, MG = GB * S;
constexpr int TOPK = 256;

__device__ __forceinline__ float wave_sum(float v) {
#pragma unroll
    for (int o = 1; o < 64; o <<= 1) v += __shfl_xor(v, o);
    return v;
}
__device__ __forceinline__ float wave_max(float v) {
#pragma unroll
    for (int o = 1; o < 64; o <<= 1) v = fmaxf(v, __shfl_xor(v, o));
    return v;
}
__device__ __forceinline__ float sigmoidf_(float x) { return 1.f / (1.f + expf(-x)); }

__global__ __launch_bounds__(256) void k_rmsnorm(const float* x, const float* __restrict__ g, const float* res, float* out, int rows) {
    const int row = blockIdx.x * 4 + (threadIdx.x >> 6), lane = threadIdx.x & 63;
    if (row >= rows) return;
    const float4* xr = (const float4*)(x + (size_t)row * D);
    float4 v[4]; float s = 0.f;
#pragma unroll
    for (int j = 0; j < 4; ++j) { v[j] = xr[lane + 64 * j]; s += v[j].x * v[j].x + v[j].y * v[j].y + v[j].z * v[j].z + v[j].w * v[j].w; }
    s = wave_sum(s);
    const float r = rsqrtf(s * (1.f / D) + 1e-6f);
#pragma unroll
    for (int j = 0; j < 4; ++j) {
        const float4 gg = ((const float4*)g)[lane + 64 * j];
        float4 o; o.x = v[j].x * r * gg.x; o.y = v[j].y * r * gg.y; o.z = v[j].z * r * gg.z; o.w = v[j].w * r * gg.w;
        if (res) { const float4 rr = ((const float4*)(res + (size_t)row * D))[lane + 64 * j]; o.x += rr.x; o.y += rr.y; o.z += rr.z; o.w += rr.w; }
        ((float4*)(out + (size_t)row * D))[lane + 64 * j] = o;
    }
}

template <int ACT>
__global__ __launch_bounds__(256) void k_gemm(const float* __restrict__ A, int lda, const float* __restrict__ Bm, int ldb, float* __restrict__ C, int ldc, int Nc, int K) {
    __shared__ float As[16][68];
    __shared__ float Bs[16][68];
    const int tid = threadIdx.x, tx = tid & 15, ty = tid >> 4;
    const int m0 = blockIdx.y * 64, n0 = blockIdx.x * 64;
    float acc[4][4];
#pragma unroll
    for (int i = 0; i < 4; ++i)
#pragma unroll
        for (int j = 0; j < 4; ++j) acc[i][j] = 0.f;
    const int ar = tid >> 2, ac = (tid & 3) * 4;
    const int br = tid >> 4, bc = (tid & 15) * 4;
    for (int k0 = 0; k0 < K; k0 += 16) {
        const float4 av = *(const float4*)(A + (size_t)(m0 + ar) * lda + k0 + ac);
        float4 bv = make_float4(0.f, 0.f, 0.f, 0.f);
        if (n0 + bc < Nc) bv = *(const float4*)(Bm + (size_t)(k0 + br) * ldb + n0 + bc);
        __syncthreads();
        As[ac + 0][ar] = av.x; As[ac + 1][ar] = av.y; As[ac + 2][ar] = av.z; As[ac + 3][ar] = av.w;
        *(float4*)&Bs[br][bc] = bv;
        __syncthreads();
#pragma unroll
        for (int k = 0; k < 16; ++k) {
            const float4 a4 = *(const float4*)&As[k][ty * 4];
            const float4 b4 = *(const float4*)&Bs[k][tx * 4];
            const float a_[4] = {a4.x, a4.y, a4.z, a4.w}, b_[4] = {b4.x, b4.y, b4.z, b4.w};
#pragma unroll
            for (int i = 0; i < 4; ++i)
#pragma unroll
                for (int j = 0; j < 4; ++j) acc[i][j] = fmaf(a_[i], b_[j], acc[i][j]);
        }
    }
    if (n0 + tx * 4 < Nc) {
#pragma unroll
        for (int i = 0; i < 4; ++i) {
            float4 o = make_float4(acc[i][0], acc[i][1], acc[i][2], acc[i][3]);
            if (ACT == 1) { o.x = fmaxf(o.x, 0.f); o.x *= o.x; o.y = fmaxf(o.y, 0.f); o.y *= o.y; o.z = fmaxf(o.z, 0.f); o.z *= o.z; o.w = fmaxf(o.w, 0.f); o.w *= o.w; }
            *(float4*)(C + (size_t)(m0 + ty * 4 + i) * ldc + n0 + tx * 4) = o;
        }
    }
}

__global__ __launch_bounds__(256) void k_rwkv_prep(const float* __restrict__ z, const float* __restrict__ mu, const float* __restrict__ w0, const float* __restrict__ w2,
                                                   const float* __restrict__ a0, const float* __restrict__ a2, const float* __restrict__ g2, const float* __restrict__ k_k, const float* __restrict__ k_a,
                                                   float* R, float* W, float* K, float* V, float* KK, float* BB, float* G) {
    __shared__ float zs[RCOLS];
    const int t = blockIdx.x, tid = threadIdx.x;
    const bool first = (t % S) == 0;
    const float* zr = z + (size_t)t * ZC;
    for (int c = tid; c < RCOLS; c += 256) { const float zc = zr[c]; const float zp = first ? 0.f : zr[c - ZC]; zs[c] = zc + (zp - zc) * mu[c]; }
    __syncthreads();
    if (tid < 64) zs[512 + tid] = tanhf(zs[512 + tid]);
    if (tid >= 64 && tid < 192) zs[1664 + tid - 64] = sigmoidf_(zs[1664 + tid - 64]);
    __syncthreads();
    for (int c = tid; c < 512; c += 256) {
        float aw = w0[c], aa = a0[c], ag = 0.f;
        for (int j = 0; j < 64; ++j) { aw = fmaf(zs[512 + j], w2[j * 512 + c], aw); aa = fmaf(zs[1600 + j], a2[j * 512 + c], aa); }
        for (int j = 0; j < 128; ++j) ag = fmaf(zs[1664 + j], g2[j * 512 + c], ag);
        const float decay = expf(-0.6065306597126334f * sigmoidf_(aw));
        const float a = sigmoidf_(aa);
        const float k = zs[576 + c];
        float kk = k * k_k[c];
        const float ss = wave_sum(kk * kk);
        kk = kk / fmaxf(sqrtf(ss), 1e-12f);
        const size_t o = (size_t)t * 512 + c;
        R[o] = zs[c]; W[o] = decay; K[o] = k * (1.f + (a - 1.f) * k_a[c]); V[o] = zs[1088 + c]; KK[o] = kk; BB[o] = kk * a; G[o] = ag;
    }
}

__global__ __launch_bounds__(256) void k_rwkv_scan(const float* __restrict__ R, const float* __restrict__ W, const float* __restrict__ K, const float* __restrict__ V, const float* __restrict__ KK, const float* __restrict__ BB, float* __restrict__ O) {
    constexpr int TS = 16;
    __shared__ float sh[TS][6][64];
    const int b = blockIdx.x / 8, h = blockIdx.x % 8, tid = threadIdx.x, vr = tid >> 2, kq = tid & 3;
    float st[16];
#pragma unroll
    for (int i = 0; i < 16; ++i) st[i] = 0.f;
    for (int t0 = 0; t0 < S; t0 += TS) {
        __syncthreads();
#define LDA(a, P) for (int i = tid; i < TS * 64; i += 256) { const int c = i & 63, s = i >> 6; sh[s][a][c] = P[(size_t)(b * S + t0 + s) * 512 + h * 64 + c]; }
        LDA(0, R) LDA(1, W) LDA(2, K) LDA(3, V) LDA(4, KK) LDA(5, BB)
#undef LDA
        __syncthreads();
        for (int s = 0; s < TS; ++s) {
            float sa = 0.f;
#pragma unroll
            for (int i = 0; i < 16; ++i) sa = fmaf(st[i], sh[s][4][kq * 16 + i], sa);
            sa += __shfl_xor(sa, 1); sa += __shfl_xor(sa, 2);
            sa = -sa;
            const float vv = sh[s][3][vr];
            float o = 0.f;
#pragma unroll
            for (int i = 0; i < 16; ++i) {
                const int c = kq * 16 + i;
                st[i] = st[i] * sh[s][1][c] + sa * sh[s][5][c] + vv * sh[s][2][c];
                o = fmaf(st[i], sh[s][0][c], o);
            }
            o += __shfl_xor(o, 1); o += __shfl_xor(o, 2);
            if (kq == 0) O[(size_t)(b * S + t0 + s) * 512 + h * 64 + vr] = o;
        }
    }
}

__global__ __launch_bounds__(256) void k_rwkv_out(const float* __restrict__ O, const float* __restrict__ R, const float* __restrict__ K, const float* __restrict__ V, const float* __restrict__ G,
                                                  const float* __restrict__ r_k, const float* __restrict__ ln_g, const float* __restrict__ ln_b, float* __restrict__ y) {
    const int w = blockIdx.x * 4 + (threadIdx.x >> 6), lane = threadIdx.x & 63;
    const int t = w >> 3, h = w & 7;
    const size_t o = (size_t)t * 512 + h * 64 + lane;
    const float ov = O[o];
    const float mean = wave_sum(ov) * (1.f / 64.f);
    const float dv = ov - mean;
    const float var = wave_sum(dv * dv) * (1.f / 64.f);
    float res = dv * rsqrtf(var + 64e-5f) * ln_g[h * 64 + lane] + ln_b[h * 64 + lane];
    const float bonus = wave_sum(R[o] * K[o] * r_k[h * 64 + lane]);
    res += bonus * V[o];
    y[(size_t)t * D + h * 64 + lane] = res * G[o];
}

__global__ __launch_bounds__(256) void k_idx_ln(const float* __restrict__ z, const float* __restrict__ g, const float* __restrict__ bta, float* __restrict__ KI) {
    const int t = blockIdx.x * 4 + (threadIdx.x >> 6), lane = threadIdx.x & 63;
    const float v = z[(size_t)t * ZC + 3840 + lane];
    const float mean = wave_sum(v) * (1.f / 64.f);
    const float dv = v - mean;
    const float var = wave_sum(dv * dv) * (1.f / 64.f);
    KI[(size_t)t * 64 + lane] = dv * rsqrtf(var + 1e-6f) * g[lane] + bta[lane];
}

__global__ __launch_bounds__(256) void k_idx_scores(const float* __restrict__ z, const float* __restrict__ KI, float* __restrict__ SC) {
    const int j = blockIdx.x, i = blockIdx.y, b = blockIdx.z;
    if (j > i) return;
    __shared__ float ks[64][68];
    const int tid = threadIdx.x, q = tid >> 2, part = tid & 3;
    for (int e = tid; e < 64 * 16; e += 256) { const int r = e >> 4, c4 = (e & 15) * 4; *(float4*)&ks[r][c4] = *(const float4*)(KI + (size_t)(b * S + j * 64 + r) * 64 + c4); }
    __syncthreads();
    const int t = b * S + i * 64 + q;
    const float* zr = z + (size_t)t * ZC;
    float sc[16];
#pragma unroll
    for (int k = 0; k < 16; ++k) sc[k] = 0.f;
#pragma unroll 1
    for (int h = 0; h < 8; ++h) {
        const float wv = zr[3904 + h] * 0.35355339059327373f;
        float dot[16];
#pragma unroll
        for (int k = 0; k < 16; ++k) dot[k] = 0.f;
#pragma unroll 1
        for (int d0 = 0; d0 < 64; d0 += 16) {
            float qv[16];
#pragma unroll
            for (int d = 0; d < 16; d += 4) { const float4 v4 = *(const float4*)(zr + 3328 + h * 64 + d0 + d); qv[d] = v4.x; qv[d + 1] = v4.y; qv[d + 2] = v4.z; qv[d + 3] = v4.w; }
#pragma unroll
            for (int k = 0; k < 16; ++k) {
#pragma unroll
                for (int d = 0; d < 16; d += 4) { const float4 k4 = *(const float4*)&ks[part * 16 + k][d0 + d]; dot[k] = fmaf(qv[d], k4.x, dot[k]); dot[k] = fmaf(qv[d + 1], k4.y, dot[k]); dot[k] = fmaf(qv[d + 2], k4.z, dot[k]); dot[k] = fmaf(qv[d + 3], k4.w, dot[k]); }
            }
        }
#pragma unroll
        for (int k = 0; k < 16; ++k) sc[k] = fmaf(wv, fmaxf(dot[k] * 0.125f, 0.f), sc[k]);
    }
#pragma unroll
    for (int k = 0; k < 16; ++k) SC[(size_t)t * S + j * 64 + part * 16 + k] = sc[k];
}

__device__ __forceinline__ unsigned fkey(float f) { f = f + 0.0f; const unsigned u = __float_as_uint(f); return (u & 0x80000000u) ? ~u : (u | 0x80000000u); }
__global__ __launch_bounds__(256) void k_select(const float* __restrict__ SC, int* __restrict__ SEL, int* __restrict__ CNT) {
    const int t = blockIdx.x * 4 + (threadIdx.x >> 6), lane = threadIdx.x & 63;
    const int pos = t % S, n = (pos / 64 + 1) * 64, nreg = n / 64;
    const float* sr = SC + (size_t)t * S;
    int* sel = SEL + (size_t)t * TOPK;
    if (n <= TOPK) { for (int i = lane; i < n; i += 64) sel[i] = i; if (lane == 0) CNT[t] = n; return; }
    unsigned key[32];
#pragma unroll
    for (int r = 0; r < 32; ++r) key[r] = (r < nreg) ? fkey(sr[r * 64 + lane]) : 0u;
    unsigned T = 0u;
    for (int bit = 31; bit >= 0; --bit) {
        const unsigned cand = T | (1u << bit);
        int cnt = 0;
#pragma unroll
        for (int r = 0; r < 32; ++r) cnt += __popcll(__ballot(key[r] >= cand));
        if (cnt >= TOPK) T = cand;
    }
    int cgt = 0;
#pragma unroll
    for (int r = 0; r < 32; ++r) cgt += __popcll(__ballot(key[r] > T));
    int quota = TOPK - cgt;
    int outp = 0;
#pragma unroll
    for (int r = 0; r < 32; ++r) {
        if (r < nreg) {
            const bool gt = key[r] > T, eq = key[r] == T;
            const unsigned long long meq = __ballot(eq);
            const int eqrank = __popcll(meq & ((1ull << lane) - 1ull));
            const bool take = gt || (eq && eqrank < quota);
            const unsigned long long mt = __ballot(take);
            const int p = outp + __popcll(mt & ((1ull << lane) - 1ull));
            if (take) sel[p] = r * 64 + lane;
            outp += __popcll(mt);
            const int neq = __popcll(meq);
            quota = quota > neq ? quota - neq : 0;
        }
    }
    if (lane == 0) CNT[t] = outp;
}

__device__ __forceinline__ int t5_bucket(int rel) {
    const int n = rel < 0 ? -rel : rel;
    int bk;
    if (n < 8) bk = n; else if (n < 12) bk = 8; else if (n < 16) bk = 9; else if (n < 23) bk = 10; else if (n < 32) bk = 11; else if (n < 46) bk = 12; else if (n < 64) bk = 13; else if (n < 91) bk = 14; else bk = 15;
    return (rel > 0 ? 16 : 0) + bk;
}

__global__ __launch_bounds__(256) void k_dsa_attn(const float* __restrict__ z, const int* __restrict__ SEL, const int* __restrict__ CNT, const float* __restrict__ rel_bias, float* __restrict__ y) {
    __shared__ float qs[512];
    __shared__ float ps[8][256];
    __shared__ float red[8][4];
    __shared__ int sidx[256];
    const int t = blockIdx.x, tid = threadIdx.x, lane = tid & 63, wv = tid >> 6;
    const int bpos = t % S, tb = t - bpos;
    const float* zr = z + (size_t)t * ZC;
    const int cnt = CNT[t];
    for (int c = tid; c < 512; c += 256) qs[c] = zr[1792 + c];
    const bool act = tid < cnt;
    const int s = act ? SEL[(size_t)t * TOPK + tid] : 0;
    sidx[tid] = s;
    __syncthreads();
    const float* kr = z + (size_t)(tb + s) * ZC + 2304;
    const int bk = t5_bucket(s - bpos);
    float lg[8];
#pragma unroll
    for (int h = 0; h < 8; ++h) {
        float dsum = 0.f;
        for (int d = 0; d < 64; d += 4) { const float4 k4 = *(const float4*)(kr + h * 64 + d); dsum = fmaf(qs[h * 64 + d], k4.x, dsum); dsum = fmaf(qs[h * 64 + d + 1], k4.y, dsum); dsum = fmaf(qs[h * 64 + d + 2], k4.z, dsum); dsum = fmaf(qs[h * 64 + d + 3], k4.w, dsum); }
        lg[h] = act ? dsum * 0.125f + rel_bias[bk * 8 + h] : -1e30f;
    }
#pragma unroll
    for (int h = 0; h < 8; ++h) { const float m = wave_max(lg[h]); if (lane == 0) red[h][wv] = m; }
    __syncthreads();
    float e[8];
#pragma unroll
    for (int h = 0; h < 8; ++h) { const float m = fmaxf(fmaxf(red[h][0], red[h][1]), fmaxf(red[h][2], red[h][3])); e[h] = act ? expf(lg[h] - m) : 0.f; }
    __syncthreads();
#pragma unroll
    for (int h = 0; h < 8; ++h) { const float sm = wave_sum(e[h]); if (lane == 0) red[h][wv] = sm; }
    __syncthreads();
#pragma unroll
    for (int h = 0; h < 8; ++h) { const float sm = red[h][0] + red[h][1] + red[h][2] + red[h][3]; ps[h][tid] = e[h] / sm; }
    __syncthreads();
    for (int c = tid; c < 512; c += 256) {
        const int h = c >> 6; float acc = 0.f;
        for (int j = 0; j < cnt; ++j) acc = fmaf(ps[h][j], z[(size_t)(tb + sidx[j]) * ZC + 2816 + c], acc);
        y[(size_t)t * D + 512 + c] = acc;
    }
}

__global__ __launch_bounds__(256) void k_gate_mul(const float* __restrict__ gate, float* __restrict__ ple, size_t n4) {
    const size_t i = (size_t)blockIdx.x * 256 + threadIdx.x;
    if (i >= n4) return;
    const float4 g = ((const float4*)gate)[i]; float4 p = ((float4*)ple)[i];
    p.x *= sigmoidf_(g.x); p.y *= sigmoidf_(g.y); p.z *= sigmoidf_(g.z); p.w *= sigmoidf_(g.w);
    ((float4*)ple)[i] = p;
}

extern "C" void kernel_launch(void* const* d_in, const int* in_sizes, int n_in, void* d_out, int out_size, void* d_ws, size_t ws_size, hipStream_t stream) {
    const float* x = (const float*)d_in[0];
    const float* p = (const float*)d_in[1];
    const float* w_in = (const float*)d_in[2];
    const float* mu = (const float*)d_in[3];
    const float* w0 = (const float*)d_in[4];
    const float* w2 = (const float*)d_in[5];
    const float* a0 = (const float*)d_in[6];
    const float* a2 = (const float*)d_in[7];
    const float* g2 = (const float*)d_in[8];
    const float* k_k = (const float*)d_in[9];
    const float* k_a = (const float*)d_in[10];
    const float* r_k = (const float*)d_in[11];
    const float* ln_g = (const float*)d_in[12];
    const float* ln_b = (const float*)d_in[13];
    const float* iln_g = (const float*)d_in[14];
    const float* iln_b = (const float*)d_in[15];
    const float* rel_bias = (const float*)d_in[16];
    const float* w_out = (const float*)d_in[17];
    const float* w_ffn1 = (const float*)d_in[18];
    const float* w_ffn2 = (const float*)d_in[19];
    const float* w_ple = (const float*)d_in[20];
    const float* w_gate = (const float*)d_in[21];
    const float* n_mix_pre = (const float*)d_in[22];
    const float* n_mix_post = (const float*)d_in[23];
    const float* n_ffn_pre = (const float*)d_in[24];
    const float* n_ffn_post = (const float*)d_in[25];
    const float* n_ple_pre = (const float*)d_in[26];
    const float* n_ple_post = (const float*)d_in[27];
    float* out = (float*)d_out;
    const size_t MiB = 1u << 20;
    if (ws_size < 250 * MiB) { fprintf(stderr, "ws too small: %zu\n", ws_size); return; }
    char* ws = (char*)d_ws;
    float* Z = (float*)(ws + 0);
    float* Hn = (float*)(ws + 64 * MiB);
    float* Rb = (float*)(ws + 80 * MiB);
    float* Wb = Rb + (size_t)MG * 512, *Kb = Wb + (size_t)MG * 512, *Vb = Kb + (size_t)MG * 512, *KKb = Vb + (size_t)MG * 512, *BBb = KKb + (size_t)MG * 512, *Gb = BBb + (size_t)MG * 512;
    float* Ob = (float*)(ws + 136 * MiB);
    float* SC = (float*)(ws + 144 * MiB);
    int* SEL = (int*)(ws + 176 * MiB);
    int* CNT = (int*)(ws + 180 * MiB);
    float* KI = (float*)(ws + 181 * MiB);
    float* Y = (float*)(ws + 182 * MiB);
    float* T1 = (float*)(ws + 198 * MiB);
    float* T2 = (float*)(ws + 214 * MiB);

    for (int g = 0; g < NB / GB; ++g) {
        const float* xg = x + (size_t)g * MG * D;
        float* og = out + (size_t)g * MG * D;
        const float* pg = p + (size_t)g * MG * PLE;
        k_rmsnorm<<<MG / 4, 256, 0, stream>>>(xg, n_mix_pre, nullptr, Hn, MG);
        k_gemm<0><<<dim3((ZC + 63) / 64, MG / 64), 256, 0, stream>>>(Hn, D, w_in, ZC, Z, ZC, ZC, D);
        k_rwkv_prep<<<MG, 256, 0, stream>>>(Z, mu, w0, w2, a0, a2, g2, k_k, k_a, Rb, Wb, Kb, Vb, KKb, BBb, Gb);
        k_rwkv_scan<<<GB * 8, 256, 0, stream>>>(Rb, Wb, Kb, Vb, KKb, BBb, Ob);
        k_rwkv_out<<<MG * 8 / 4, 256, 0, stream>>>(Ob, Rb, Kb, Vb, Gb, r_k, ln_g, ln_b, Y);
        k_idx_ln<<<MG / 4, 256, 0, stream>>>(Z, iln_g, iln_b, KI);
        k_idx_scores<<<dim3(32, 32, GB), 256, 0, stream>>>(Z, KI, SC);
        k_select<<<MG / 4, 256, 0, stream>>>(SC, SEL, CNT);
        k_dsa_attn<<<MG, 256, 0, stream>>>(Z, SEL, CNT, rel_bias, Y);
        k_gemm<0><<<dim3(D / 64, MG / 64), 256, 0, stream>>>(Y, D, w_out, D, T1, D, D, D);
        k_rmsnorm<<<MG / 4, 256, 0, stream>>>(T1, n_mix_post, xg, og, MG);
        k_rmsnorm<<<MG / 4, 256, 0, stream>>>(og, n_ffn_pre, nullptr, Hn, MG);
        k_gemm<1><<<dim3(DFF / 64, MG / 64), 256, 0, stream>>>(Hn, D, w_ffn1, DFF, Z, DFF, DFF, D);
        k_gemm<0><<<dim3(D / 64, MG / 64), 256, 0, stream>>>(Z, DFF, w_ffn2, D, T1, D, D, DFF);
        k_rmsnorm<<<MG / 4, 256, 0, stream>>>(T1, n_ffn_post, og, og, MG);
        k_rmsnorm<<<MG / 4, 256, 0, stream>>>(og, n_ple_pre, nullptr, Hn, MG);
        k_gemm<0><<<dim3(D / 64, MG / 64), 256, 0, stream>>>(Hn, D, w_gate, D, T1, D, D, D);
        k_gemm<0><<<dim3(D / 64, MG / 64), 256, 0, stream>>>(pg, PLE, w_ple, D, T2, D, D, PLE);
        k_gate_mul<<<(MG * D / 4 + 255) / 256, 256, 0, stream>>>(T1, T2, (size_t)MG * D / 4);
        k_rmsnorm<<<MG / 4, 256, 0, stream>>>(T2, n_ple_post, og, og, MG);
    }
}
```
